# Optimizing an MI355X kernel written in HIP

```python
import math
import jax, jax.numpy as jnp
from jax import lax
import numpy as np

D_MODEL = 1024
BATCH = 2
SEQ = 8192
DEPTH = 1
DEC_BATCH = 16
DEC_SEQ = 64
PAST_LEN = 4096

CHUNK = 64
HEAD_DIM = 64
SB_WIDTH = D_MODEL // 2
SB_HEADS = SB_WIDTH // HEAD_DIM
POOL_WIDTH = D_MODEL // 4
POOL_WINDOWS = (2, 4, 8, 16)
POOL_GROUPS = len(POOL_WINDOWS)
POOL_GROUP_DIM = POOL_WIDTH // POOL_GROUPS
POOL_STATE = max(POOL_WINDOWS) - 1
XA_WIDTH = D_MODEL // 4
XA_HEADS = 4
XA_HEAD_DIM = XA_WIDTH // XA_HEADS
N_MEM = 256
MIX_WIDTH = SB_WIDTH + POOL_WIDTH + XA_WIDTH
IN_SIZES = (SB_WIDTH, SB_WIDTH, SB_WIDTH, SB_WIDTH, POOL_WIDTH, POOL_WIDTH, XA_WIDTH, XA_WIDTH)
IN_WIDTH = sum(IN_SIZES)
IN_SPLITS = tuple(int(i) for i in np.cumsum(IN_SIZES)[:-1])
Q_BLOCK = 128
EPS = 1e-6

kernel_name = "stick_breaking_pool_memory_hybrid_step"


def rms_norm(x, g):
    xf = x.astype(jnp.float32)
    y = xf * lax.rsqrt(jnp.mean(xf * xf, axis=-1, keepdims=True) + EPS)
    return (y * g.astype(jnp.float32)).astype(x.dtype)


def _sb_block(q_blk, q_pos, k, v, k_pos):
    z = jnp.einsum('bqhd,bkhd->bhqk', q_blk, k).astype(jnp.float32) / math.sqrt(HEAD_DIM)
    causal = k_pos[None, :] < q_pos[:, None]
    log_beta = jax.nn.log_sigmoid(z)
    log_rest = jnp.where(causal, jax.nn.log_sigmoid(-z), 0.0)
    tail = lax.cumsum(log_rest, axis=3, reverse=True) - log_rest
    w = jnp.where(causal, jnp.exp(log_beta + tail), 0.0)
    return jnp.einsum('bhqk,bkhd->bqhd', w.astype(v.dtype), v)


def stick_breaking(q, k, v, q_pos, k_pos):
    B, T, H, Dh = q.shape
    if T <= Q_BLOCK:
        return _sb_block(q, q_pos, k, v, k_pos)
    nb = T // Q_BLOCK
    qb = q.reshape(B, nb, Q_BLOCK, H, Dh).transpose(1, 0, 2, 3, 4)
    pb = q_pos.reshape(nb, Q_BLOCK)
    ob = lax.map(lambda a: _sb_block(a[0], a[1], k, v, k_pos), (qb, pb))
    return ob.transpose(1, 0, 2, 3, 4).reshape(B, T, H, Dh)


def multiscale_pool(u, hist, start):
    B, T, C = u.shape
    up = jnp.concatenate([hist, u], axis=1).astype(jnp.float32)
    cs = jnp.concatenate([jnp.zeros((B, 1, C), jnp.float32), jnp.cumsum(up, axis=1)], axis=1)
    pos = start + jnp.arange(T)
    hi = cs[:, POOL_STATE + 1:POOL_STATE + 1 + T]
    means = []
    for g, w in enumerate(POOL_WINDOWS):
        sl = slice(g * POOL_GROUP_DIM, (g + 1) * POOL_GROUP_DIM)
        lo = cs[:, POOL_STATE + 1 - w:POOL_STATE + 1 - w + T, sl]
        cnt = jnp.minimum(pos + 1, w).astype(jnp.float32)
        means.append((hi[..., sl] - lo) / cnt[None, :, None])
    mean = jnp.concatenate(means, axis=-1)
    return (mean - u.astype(jnp.float32)).astype(u.dtype)


def memory_kv(mem, g_mem, w_mem_kv):
    B, N, _ = mem.shape
    kv = rms_norm(mem, g_mem) @ w_mem_kv
    mk, mv = jnp.split(kv, 2, axis=-1)
    return (mk.reshape(B, N, XA_HEADS, XA_HEAD_DIM), mv.reshape(B, N, XA_HEADS, XA_HEAD_DIM))


def memory_attend(q, mk, mv):
    s = jnp.einsum('bthd,bnhd->bhtn', q, mk).astype(jnp.float32) / math.sqrt(XA_HEAD_DIM)
    p = jax.nn.softmax(s, axis=-1)
    return jnp.einsum('bhtn,bnhd->bthd', p.astype(mv.dtype), mv)


def mixer_layer(x, start, k_past, v_past, pool_hist, mk, mv, g_norm, w_in, pool_w, pool_scale, w_out):
    B, T, _ = x.shape
    h = rms_norm(x, g_norm)
    z = h @ w_in
    q_sb, k_sb, v_sb, g_sb, u_pool, g_pool, q_xa, g_xa = jnp.split(z, IN_SPLITS, axis=-1)
    q_sb = q_sb.reshape(B, T, SB_HEADS, HEAD_DIM)
    k_new = k_sb.reshape(B, T, SB_HEADS, HEAD_DIM)
    v_new = v_sb.reshape(B, T, SB_HEADS, HEAD_DIM)
    if k_past is None:
        k_all, v_all = k_new, v_new
    else:
        k_all = jnp.concatenate([k_past, k_new], axis=1)
        v_all = jnp.concatenate([v_past, v_new], axis=1)
    q_pos = start + jnp.arange(T)
    k_pos = jnp.arange(k_all.shape[1])
    o_sb = stick_breaking(q_sb, k_all, v_all, q_pos, k_pos).reshape(B, T, SB_WIDTH)
    pooled = multiscale_pool(u_pool, pool_hist, start).reshape(B, T, POOL_GROUPS, POOL_GROUP_DIM)
    o_pool = jnp.einsum('btgc,gcd->btgd', pooled, pool_w).reshape(B, T, POOL_WIDTH) * pool_scale
    new_hist = jnp.concatenate([pool_hist, u_pool], axis=1)[:, -POOL_STATE:]
    o_xa = memory_attend(q_xa.reshape(B, T, XA_HEADS, XA_HEAD_DIM), mk, mv).reshape(B, T, XA_WIDTH)
    mixed = jnp.concatenate([o_sb * jax.nn.silu(g_sb), o_pool * jax.nn.silu(g_pool), o_xa * jax.nn.silu(g_xa)], axis=-1)
    return x + mixed @ w_out, k_new, v_new, new_hist


def setup_inputs(seed: int = 0) -> dict:
    key = jax.random.key(seed)
    ks = jax.random.split(key, 17)

    def nrm(k, shape, s=1.0):
        return s * jax.random.normal(k, shape, jnp.float32)

    return {
        "x_prompt": nrm(ks[0], (BATCH, SEQ, D_MODEL)),
        "x_sample": nrm(ks[1], (DEC_BATCH, DEC_SEQ, D_MODEL)),
        "cache_sb_k": nrm(ks[2], (DEPTH, DEC_BATCH, PAST_LEN, SB_HEADS, HEAD_DIM)),
        "cache_sb_v": nrm(ks[3], (DEPTH, DEC_BATCH, PAST_LEN, SB_HEADS, HEAD_DIM)),
        "state_pool": nrm(ks[4], (DEPTH, DEC_BATCH, POOL_STATE, POOL_WIDTH)),
        "cache_mem_k": nrm(ks[5], (DEPTH, DEC_BATCH, N_MEM, XA_HEADS, XA_HEAD_DIM)),
        "cache_mem_v": nrm(ks[6], (DEPTH, DEC_BATCH, N_MEM, XA_HEADS, XA_HEAD_DIM)),
        "mem_prompt": nrm(ks[7], (BATCH, N_MEM, D_MODEL)),
        "g_norm": 1.0 + nrm(ks[8], (DEPTH, D_MODEL), 0.01),
        "w_in": nrm(ks[9], (DEPTH, D_MODEL, IN_WIDTH), D_MODEL ** -0.5),
        "pool_w": nrm(ks[10], (DEPTH, POOL_GROUPS, POOL_GROUP_DIM, POOL_GROUP_DIM), POOL_GROUP_DIM ** -0.5),
        "pool_scale": 1.0 + nrm(ks[11], (DEPTH, POOL_WIDTH), 0.1),
        "g_mem": 1.0 + nrm(ks[12], (DEPTH, D_MODEL), 0.01),
        "w_mem_kv": nrm(ks[13], (DEPTH, D_MODEL, 2 * XA_WIDTH), D_MODEL ** -0.5),
        "w_out": nrm(ks[14], (DEPTH, MIX_WIDTH, D_MODEL), MIX_WIDTH ** -0.5),
        "g_final": 1.0 + nrm(ks[15], (D_MODEL,), 0.01),
    }


def reference(x_prompt, x_sample, cache_sb_k, cache_sb_v, state_pool, cache_mem_k, cache_mem_v, mem_prompt,
              g_norm, w_in, pool_w, pool_scale, g_mem, w_mem_kv, w_out, g_final):
    past = cache_sb_k.shape[2]
    yp, ys = x_prompt, x_sample
    kp_l, vp_l, hp_l, mkp_l, mvp_l, ks_l, vs_l, hs_l = [], [], [], [], [], [], [], []
    for l in range(DEPTH):
        mk, mv = memory_kv(mem_prompt, g_mem[l], w_mem_kv[l])
        hist0 = jnp.zeros((x_prompt.shape[0], POOL_STATE, POOL_WIDTH), x_prompt.dtype)
        yp, kp, vp, hp = mixer_layer(yp, 0, None, None, hist0, mk, mv,
                                     g_norm[l], w_in[l], pool_w[l], pool_scale[l], w_out[l])
        ys, kn, vn, hn = mixer_layer(ys, past, cache_sb_k[l], cache_sb_v[l], state_pool[l],
                                     cache_mem_k[l], cache_mem_v[l],
                                     g_norm[l], w_in[l], pool_w[l], pool_scale[l], w_out[l])
        kp_l.append(kp); vp_l.append(vp); hp_l.append(hp); mkp_l.append(mk); mvp_l.append(mv)
        ks_l.append(kn); vs_l.append(vn); hs_l.append(hn)
    y_prompt = rms_norm(yp, g_final)
    y_sample = rms_norm(ys, g_final)
    sb_k_prompt = jnp.stack(kp_l, axis=0)
    sb_v_prompt = jnp.stack(vp_l, axis=0)
    pool_prompt = jnp.stack(hp_l, axis=0)
    mem_k_prompt = jnp.stack(mkp_l, axis=0)
    mem_v_prompt = jnp.stack(mvp_l, axis=0)
    sb_k_sample = jnp.stack(ks_l, axis=0)
    sb_v_sample = jnp.stack(vs_l, axis=0)
    pool_sample = jnp.stack(hs_l, axis=0)
    return (y_prompt, y_sample, sb_k_prompt, sb_v_prompt, pool_prompt, mem_k_prompt, mem_v_prompt, sb_k_sample, sb_v_sample, pool_sample)
```

```cpp
#include <hip/hip_runtime.h>
#include <hip/hip_cooperative_groups.h>
#include <cstdio>
#include <cstdint>
namespace cg = cooperative_groups;
namespace pg8 {
#define PG8_LAS __attribute__((address_space(3)))
typedef unsigned short bf16_t;
typedef short bf16x8 __attribute__((ext_vector_type(8)));
typedef float f32x4 __attribute__((ext_vector_type(4)));
typedef unsigned u32x4 __attribute__((ext_vector_type(4)));
constexpr int BM = 256, BK = 64, HALF = 128, HTB = HALF * BK * 2  , STAGE_BYTES = 8 * HTB, NXCD = 8, WGM = 8;

__host__ __device__ __forceinline__ int lds_byte(int r, int c) { const int st = (r >> 4) * 2 + (c >> 5), rr = r & 15, cc = c & 31, ob = rr * 64 + cc * 2; return st * 1024 + (ob ^ (((ob >> 9) & 1) << 5)); }
__host__ __device__ __forceinline__ void stage_rc(int b, int& R, int& C) { const int st = b / 1024, sb = b % 1024, swz = sb ^ (((sb >> 9) & 1) << 5); R = (st >> 1) * 16 + swz / 64; C = (st & 1) * 32 + (swz % 64) / 2; }
__host__ __device__ __forceinline__ int perm32(int rho) { const int n = rho >> 4, i = rho & 15; return 8 * (i >> 2) + 4 * n + (i & 3); }

struct Unit { int pm, pn; };
struct Gemm { const bf16_t* A; const bf16_t* Bt; int M, N, K; };
struct StaticOrder {
    int nM, nN, nwg, G, c;
    __host__ __device__ void init(int M, int N, int G_, int c_) { nM = M / BM; nN = N / BM; nwg = nM * nN; G = G_; c = c_; }
    __host__ __device__ bool next(int i, Unit& u) const {
        const long L = (long)i * G + c; if (L >= nwg) return false;
        int wgid = (int)L; { const int q = nwg / NXCD, r = nwg % NXCD, xcd = wgid % NXCD, off = wgid / NXCD; wgid = (xcd < r ? xcd * (q + 1) : r * (q + 1) + (xcd - r) * q) + off; }
        const int nig = WGM * nN, gid = wgid / nig, fm = gid * WGM, gsz = (nM - fm) < WGM ? (nM - fm) : WGM;
        u.pm = fm + ((wgid % nig) % gsz); u.pn = (wgid % nig) / gsz; return true;
    }
    __device__ __forceinline__ void a_ready(const Unit&) const {}
    __device__ __forceinline__ void done(const Unit&) const {}
};
__device__ __forceinline__ unsigned cvt_pk_bf16(float lo, float hi) { unsigned r; asm volatile("v_cvt_pk_bf16_f32 %0, %1, %2" : "=v"(r) : "v"(lo), "v"(hi)); return r; }
template <class Epi, class Sched, bool ALIGN_EPI = false, bool SP2 = false>
__device__ __forceinline__ void gemm_phase(PG8_LAS unsigned char* lds, const Gemm g, const Sched& S, const Epi& E) {
    const int tid = threadIdx.x, wid = __builtin_amdgcn_readfirstlane(tid >> 6), lane = tid & 63, wr = wid >> 2, wc = wid & 3, fr = lane & 15, fq = lane >> 4;
    const int K = g.K, nt = K / BK;
    unsigned voffA[2], voffB[2];
#pragma unroll
    for (int i = 0; i < 2; ++i) { int R, C; stage_rc(tid * 16 + i * 8192, R, C); const int Rb = Epi::PERM ? ((R & ~31) + perm32(R & 31)) : R;
        voffA[i] = (unsigned)(R * K + C) * 2u; voffB[i] = (unsigned)(Rb * K + C) * 2u; }
    const size_t kstep = (size_t)(BK * 2);
    const size_t hstep = (size_t)HALF * K * 2;
    const size_t tstep = 2 * hstep;
    const unsigned ldsw = (unsigned)wid * 1024u;
    const int aoff = lds_byte(wr * 64 + fr, fq * 8), boff = lds_byte(wc * 32 + fr, fq * 8);
#define PG8_SA(b, h) (((b) * 2 + (h)) * HTB)
#define PG8_SB(b, h) ((4 + (b) * 2 + (h)) * HTB)
#define PG8_STAGE(bufoff, gbase, voff) do { _Pragma("unroll") for (int _i = 0; _i < 2; ++_i) \
        __builtin_amdgcn_global_load_lds((const unsigned*)((const char*)(gbase) + (voff)[_i]), (PG8_LAS unsigned*)(lds + (bufoff) + ldsw + _i * 8192), 16, 0, 0); } while (0)
#define PG8_LDA(dst, b, h) do { _Pragma("unroll") for (int m = 0; m < 4; ++m) _Pragma("unroll") for (int k = 0; k < 2; ++k) dst[m][k] = *(const PG8_LAS bf16x8*)(lds + PG8_SA(b, h) + aoff + m * 2048 + k * 1024); } while (0)
#define PG8_LDB(dst, b, h) do { _Pragma("unroll") for (int n = 0; n < 2; ++n) _Pragma("unroll") for (int k = 0; k < 2; ++k) dst[n][k] = *(const PG8_LAS bf16x8*)(lds + PG8_SB(b, h) + boff + n * 2048 + k * 1024); } while (0)
#define PG8_MMA(ai, bj, At, Bt) do { __builtin_amdgcn_s_setprio(1); _Pragma("unroll") for (int m = 0; m < 4; ++m) _Pragma("unroll") for (int n = 0; n < 2; ++n) _Pragma("unroll") for (int k = 0; k < 2; ++k) \
        acc[ai][bj][m][n] = __builtin_amdgcn_mfma_f32_16x16x32_bf16(Bt[n][k], At[m][k], acc[ai][bj][m][n], 0, 0, 0); __builtin_amdgcn_s_setprio(0); } while (0)
#define PG8_WAIT_V(n) asm volatile("s_waitcnt vmcnt(" #n ")" ::: "memory")
#define PG8_WAIT_L(n) asm volatile("s_waitcnt lgkmcnt(" #n ")" ::: "memory")
#define PG8_BAR __builtin_amdgcn_s_barrier()
#define PG8_SCHED __builtin_amdgcn_sched_barrier(0)
    Unit cur, nxt; int ui = 0;
    if (!S.next(0, cur)) return;
    f32x4 acc[2][2][4][2];
#pragma unroll
    for (int a = 0; a < 2; ++a)
#pragma unroll
        for (int b = 0; b < 2; ++b)
#pragma unroll
            for (int m = 0; m < 4; ++m)
#pragma unroll
                for (int n = 0; n < 2; ++n) acc[a][b][m][n] = (f32x4){0.f, 0.f, 0.f, 0.f};
    bf16x8 At[4][2], B0[2][2], B1[2][2];
    const char* cA = (const char*)g.A + (size_t)cur.pm * tstep; const char* cB = (const char*)g.Bt + (size_t)cur.pn * tstep;
    S.a_ready(cur);
    if constexpr (SP2) {
        PG8_STAGE(PG8_SB(0, 0), cB, voffB); PG8_STAGE(PG8_SB(0, 1), cB + hstep, voffB); PG8_STAGE(PG8_SA(0, 0), cA, voffA); PG8_STAGE(PG8_SA(0, 1), cA + hstep, voffA);
        if (wr == 1) PG8_BAR;
        PG8_WAIT_V(2); PG8_BAR;
        PG8_STAGE(PG8_SB(1, 0), cB + kstep, voffB); PG8_STAGE(PG8_SA(1, 0), cA + kstep, voffA); PG8_STAGE(PG8_SB(1, 1), cB + hstep + kstep, voffB);
        PG8_WAIT_V(6); PG8_BAR;
    } else {
        PG8_STAGE(PG8_SB(0, 0), cB, voffB); PG8_STAGE(PG8_SA(0, 0), cA, voffA); PG8_STAGE(PG8_SB(0, 1), cB + hstep, voffB); PG8_STAGE(PG8_SA(0, 1), cA + hstep, voffA);
        if (wr == 1) PG8_BAR;
        PG8_WAIT_V(4); PG8_BAR;
        PG8_STAGE(PG8_SB(1, 0), cB + kstep, voffB); PG8_STAGE(PG8_SA(1, 0), cA + kstep, voffA); PG8_STAGE(PG8_SB(1, 1), cB + hstep + kstep, voffB);
        PG8_WAIT_V(6); PG8_BAR;
    }
    for (;;) {
        const bool has_next = S.next(ui + 1, nxt);
        const char* nA = has_next ? (const char*)g.A + (size_t)nxt.pm * tstep : cA; const char* nB = has_next ? (const char*)g.Bt + (size_t)nxt.pn * tstep : cB;
        for (int t = 0; t < nt; t += 2) {
            const bool last = (t == nt - 2);
            const char* a1 = cA + (size_t)(t + 1) * kstep;
            const char* a2 = last ? nA : cA + (size_t)(t + 2) * kstep; const char* b2 = last ? nB : cB + (size_t)(t + 2) * kstep;
            const char* a3 = a2 + kstep; const char* b3 = b2 + kstep;
            if (last && has_next) S.a_ready(nxt);
            if constexpr (SP2) {
            PG8_LDB(B0, 0, 0); PG8_LDB(B1, 0, 1); PG8_SCHED; PG8_LDA(At, 0, 0); PG8_STAGE(PG8_SA(1, 1), a1 + hstep, voffA);
            PG8_WAIT_V(8); PG8_WAIT_L(0); PG8_BAR; PG8_MMA(0, 0, At, B0); PG8_MMA(0, 1, At, B1); PG8_BAR; PG8_SCHED;
            PG8_LDA(At, 0, 1); PG8_STAGE(PG8_SB(0, 0), b2, voffB); PG8_STAGE(PG8_SB(0, 1), b2 + hstep, voffB); PG8_STAGE(PG8_SA(0, 0), a2, voffA);
            PG8_WAIT_V(8); PG8_WAIT_L(0); PG8_BAR; PG8_MMA(1, 0, At, B0); PG8_MMA(1, 1, At, B1); PG8_BAR; PG8_SCHED;
            PG8_LDB(B0, 1, 0); PG8_LDB(B1, 1, 1); PG8_SCHED; PG8_LDA(At, 1, 0); PG8_STAGE(PG8_SA(0, 1), a2 + hstep, voffA);
            PG8_WAIT_V(8); PG8_WAIT_L(0); PG8_BAR; PG8_MMA(0, 0, At, B0); PG8_MMA(0, 1, At, B1); PG8_BAR; PG8_SCHED;
            PG8_LDA(At, 1, 1); PG8_STAGE(PG8_SB(1, 0), b3, voffB); PG8_STAGE(PG8_SB(1, 1), b3 + hstep, voffB); PG8_STAGE(PG8_SA(1, 0), a3, voffA);
            PG8_WAIT_V(8); PG8_WAIT_L(0); PG8_BAR; PG8_MMA(1, 0, At, B0); PG8_MMA(1, 1, At, B1); PG8_BAR; PG8_SCHED;
            } else {
            PG8_LDB(B0, 0, 0); PG8_SCHED; PG8_LDA(At, 0, 0); PG8_STAGE(PG8_SA(1, 1), a1 + hstep, voffA);
            PG8_WAIT_L(8); PG8_BAR; PG8_WAIT_L(0); PG8_MMA(0, 0, At, B0); PG8_BAR; PG8_SCHED;
            PG8_LDB(B1, 0, 1); PG8_STAGE(PG8_SB(0, 0), b2, voffB);
            PG8_BAR; PG8_WAIT_L(0); PG8_MMA(0, 1, At, B1); PG8_BAR;
            PG8_LDA(At, 0, 1); PG8_STAGE(PG8_SA(0, 0), a2, voffA);
            PG8_BAR; PG8_WAIT_L(0); PG8_MMA(1, 0, At, B0); PG8_BAR; PG8_SCHED;
            PG8_STAGE(PG8_SB(0, 1), b2 + hstep, voffB);
            PG8_WAIT_V(6); PG8_BAR; PG8_MMA(1, 1, At, B1); PG8_BAR;
            PG8_LDB(B0, 1, 0); PG8_SCHED; PG8_LDA(At, 1, 0); PG8_STAGE(PG8_SA(0, 1), a2 + hstep, voffA);
            PG8_WAIT_L(8); PG8_BAR; PG8_WAIT_L(0); PG8_MMA(0, 0, At, B0); PG8_BAR; PG8_SCHED;
            PG8_LDB(B1, 1, 1); PG8_STAGE(PG8_SB(1, 0), b3, voffB);
            PG8_BAR; PG8_WAIT_L(0); PG8_MMA(0, 1, At, B1); PG8_BAR;
            PG8_LDA(At, 1, 1); PG8_STAGE(PG8_SA(1, 0), a3, voffA);
            PG8_BAR; PG8_WAIT_L(0); PG8_MMA(1, 0, At, B0); PG8_BAR; PG8_SCHED;
            PG8_STAGE(PG8_SB(1, 1), b3 + hstep, voffB);
            PG8_WAIT_V(6); PG8_BAR; PG8_MMA(1, 1, At, B1); PG8_BAR;
            }
        }
        if constexpr (ALIGN_EPI) { if (wr == 0) PG8_BAR; }
        if constexpr (!Epi::AFTER_DRAIN) { E(acc, cur, wr, wc, fr, fq); S.done(cur); }
        if (!has_next) break;
#pragma unroll
        for (int a = 0; a < 2; ++a)
#pragma unroll
            for (int b = 0; b < 2; ++b)
#pragma unroll
                for (int m = 0; m < 4; ++m)
#pragma unroll
                    for (int n = 0; n < 2; ++n) acc[a][b][m][n] = (f32x4){0.f, 0.f, 0.f, 0.f};
        cur = nxt; cA = nA; cB = nB; ++ui;
        if constexpr (ALIGN_EPI) { if (wr == 1) PG8_BAR; }
    }
    PG8_WAIT_V(0);
    if constexpr (!ALIGN_EPI) { if (wr == 0) PG8_BAR; }
    PG8_BAR;
    if constexpr (Epi::AFTER_DRAIN) { E.fused(acc, cur, wr, wc, fr, fq, lds, wid, lane); S.done(cur); }
#undef PG8_SA
#undef PG8_SB
#undef PG8_STAGE
#undef PG8_LDA
#undef PG8_LDB
#undef PG8_MMA
#undef PG8_WAIT_V
#undef PG8_WAIT_L
#undef PG8_BAR
#undef PG8_SCHED
}
}

#define LAS __attribute__((address_space(3)))
typedef unsigned short bf16;
typedef short bf16x8 __attribute__((ext_vector_type(8)));
typedef short s16x4 __attribute__((ext_vector_type(4)));
typedef float f32x4 __attribute__((ext_vector_type(4)));
typedef float f32x2 __attribute__((ext_vector_type(2)));
typedef float f32x16 __attribute__((ext_vector_type(16)));
typedef unsigned u32x4 __attribute__((ext_vector_type(4)));
typedef unsigned u32x2 __attribute__((ext_vector_type(2)));
typedef __bf16 bf16x2_t __attribute__((ext_vector_type(2)));

constexpr int DM = 1024, NIN = 3072, MP = 16384, MS = 1024, MT = MP + MS, SEQ = 8192, DSEQ = 64, PAST = 4096;
constexpr int NMEM = 256;
constexpr float C2 = 0.125f * 1.4426950408889634f;
constexpr float EPS = 1e-6f;
constexpr int ZQ = 0, ZK = 512, ZV = 1024, ZGS = 1536, ZU = 2048, ZGP = 2304, ZQX = 2560, ZGX = 2816;
constexpr size_t O_Y = 0, O_KP = 17825792, O_VP = 26214400, O_PP = 34603008, O_MK = 34610688, O_MV = 34741760, O_KS = 34872832, O_VS = 35397120, O_PS = 35921408;
constexpr size_t MiB = 1u << 20;
constexpr size_t WS_WIN = 0, WS_WOUT = 6 * MiB, WS_WMEM = 8 * MiB, WS_POOLW = 9 * MiB, WS_MEMN = 10 * MiB, WS_MEMK = 11 * MiB, WS_MEMV = 14 * MiB, WS_ROWSS = 17 * MiB, WS_CTR = 19 * MiB,
                 WS_XN = 20 * MiB, WS_Z = 54 * MiB, WS_MIX = 156 * MiB, WS_END = 190 * MiB;
constexpr int LDS_BYTES = 147456;

struct Args {
    const float *x_prompt, *x_sample, *cache_k, *cache_v, *state_pool, *cache_mk, *cache_mv, *mem_prompt, *g_norm, *w_in, *pool_w, *pool_scale, *g_mem, *w_mem_kv, *w_out, *g_final;
    float* out; unsigned char* ws;
};

__device__ __forceinline__ unsigned cvtpk(float lo, float hi) { f32x2 v = {lo, hi}; bf16x2_t b = __builtin_convertvector(v, bf16x2_t); return __builtin_bit_cast(unsigned, b); }
__device__ __forceinline__ float bf_lo(unsigned w) { return __uint_as_float(w << 16); }
__device__ __forceinline__ float bf_hi(unsigned w) { return __uint_as_float(w & 0xffff0000u); }
__device__ __forceinline__ bf16x8 pack8(f32x4 a, f32x4 b) { u32x4 w; w.x = cvtpk(a.x, a.y); w.y = cvtpk(a.z, a.w); w.z = cvtpk(b.x, b.y); w.w = cvtpk(b.z, b.w); return __builtin_bit_cast(bf16x8, w); }
__device__ __forceinline__ float wave_sum(float v) {
#pragma unroll
    for (int o = 1; o < 64; o <<= 1) v += __shfl_xor(v, o);
    return v;
}
__device__ __forceinline__ int crow(int r, int h) { return (r & 3) + 8 * (r >> 2) + 4 * h; }
#define LDS_WAIT() asm volatile("s_waitcnt lgkmcnt(0)" ::: "memory")
#define MFMA32(a, b, c) __builtin_amdgcn_mfma_f32_32x32x16_bf16((a), (b), (c), 0, 0, 0)

struct EpiIn {
    static constexpr bool PERM = true, AFTER_DRAIN = false;
    bf16* Z; float* out;
    __device__ __forceinline__ void operator()(const pg8::f32x4 (&acc)[2][2][4][2], const pg8::Unit& u, int wr, int wc, int fr, int fq) const {
        const int row0 = u.pm * 256 + wr * 64 + fr, col0 = u.pn * 256 + wc * 32 + 8 * fq;
        const int pn = u.pn;
#pragma unroll
        for (int ai = 0; ai < 2; ++ai)
#pragma unroll
            for (int m = 0; m < 4; ++m) {
                const int row = row0 + ai * 128 + m * 16;
                bf16* zp = Z + (size_t)row * NIN + col0;
#pragma unroll
                for (int bj = 0; bj < 2; ++bj) {
                    const pg8::f32x4 v0 = acc[ai][bj][m][0], v1 = acc[ai][bj][m][1];
                    u32x4 w; w.x = cvtpk(v0[0], v0[1]); w.y = cvtpk(v0[2], v0[3]); w.z = cvtpk(v1[0], v1[1]); w.w = cvtpk(v1[2], v1[3]);
                    *(u32x4*)(zp + bj * 128) = w;
                    const int col = col0 + bj * 128;
                    if (pn >= 2 && pn < 6) {
                        const bool isv = pn >= 4; const int c = col - (isv ? ZV : ZK);
                        float* dst = (row < MP) ? out + (isv ? O_VP : O_KP) + (size_t)row * 512 + c : out + (isv ? O_VS : O_KS) + (size_t)(row - MP) * 512 + c;
                        *(pg8::f32x4*)dst = v0; *(pg8::f32x4*)(dst + 4) = v1;
                    } else if (pn == 8) {
                        const int c = col - ZU;
                        if (row < MP) { const int t = row & (SEQ - 1); if (t >= SEQ - 15) { float* dst = out + O_PP + (size_t)((row >> 13) * 15 + (t - (SEQ - 15))) * 256 + c; *(pg8::f32x4*)dst = v0; *(pg8::f32x4*)(dst + 4) = v1; } }
                        else { const int rs = row - MP, t = rs & 63; if (t >= DSEQ - 15) { float* dst = out + O_PS + (size_t)((rs >> 6) * 15 + (t - (DSEQ - 15))) * 256 + c; *(pg8::f32x4*)dst = v0; *(pg8::f32x4*)(dst + 4) = v1; } }
                    }
                }
            }
    }
};
struct EpiMem {
    static constexpr bool PERM = true, AFTER_DRAIN = false;
    bf16 *MK, *MV; float* out;
    __device__ __forceinline__ void operator()(const pg8::f32x4 (&acc)[2][2][4][2], const pg8::Unit& u, int wr, int wc, int fr, int fq) const {
        const int row0 = u.pm * 256 + wr * 64 + fr, c0 = wc * 32 + 8 * fq;
        bf16* B = u.pn ? MV : MK; float* F = out + (u.pn ? O_MV : O_MK);
#pragma unroll
        for (int ai = 0; ai < 2; ++ai)
#pragma unroll
            for (int m = 0; m < 4; ++m) {
                const int row = row0 + ai * 128 + m * 16;
#pragma unroll
                for (int bj = 0; bj < 2; ++bj) {
                    const pg8::f32x4 v0 = acc[ai][bj][m][0], v1 = acc[ai][bj][m][1];
                    u32x4 w; w.x = cvtpk(v0[0], v0[1]); w.y = cvtpk(v0[2], v0[3]); w.z = cvtpk(v1[0], v1[1]); w.w = cvtpk(v1[2], v1[3]);
                    const size_t o = (size_t)row * 256 + c0 + bj * 128;
                    *(u32x4*)(B + o) = w; *(pg8::f32x4*)(F + o) = v0; *(pg8::f32x4*)(F + o + 4) = v1;
                }
            }
    }
};
struct EpiOut {
    static constexpr bool PERM = false, AFTER_DRAIN = false;
    const float *xp, *xs; float* out; float* rowss;
    __device__ __forceinline__ void operator()(const pg8::f32x4 (&acc)[2][2][4][2], const pg8::Unit& u, int wr, int wc, int fr, int fq) const {
        const int col0 = u.pn * 256 + wc * 32 + 4 * fq;
        const float* X = (u.pm < MP / 256) ? xp : xs - (size_t)MP * DM;
#pragma unroll
        for (int ai = 0; ai < 2; ++ai)
#pragma unroll
            for (int m = 0; m < 4; ++m) {
                const int row = u.pm * 256 + ai * 128 + wr * 64 + m * 16 + fr; const size_t off = (size_t)row * DM + col0; float ss = 0.f;
#pragma unroll
                for (int bj = 0; bj < 2; ++bj)
#pragma unroll
                    for (int n = 0; n < 2; ++n) { const pg8::f32x4 xv = *(const pg8::f32x4*)(X + off + bj * 128 + n * 16); const pg8::f32x4 y = xv + acc[ai][bj][m][n];
                        *(pg8::f32x4*)(out + O_Y + off + bj * 128 + n * 16) = y; ss += (y[0] * y[0] + y[1] * y[1]) + (y[2] * y[2] + y[3] * y[3]); }
                ss += __shfl_xor(ss, 16); ss += __shfl_xor(ss, 32);
                if (fq == 0) rowss[(size_t)row * 16 + u.pn * 4 + wc] = ss;
            }
    }
};

__device__ __forceinline__ void transpose_item(const float* W, int K, int N, bf16* WT, LAS float* scr, int item, int lane, const float* gk, float sc) {
    const int nblk = N / 32, kb = item / nblk, nb = item % nblk, k0 = 64 * kb, n0 = 32 * nb;
#pragma unroll 8
    for (int i = 0; i < 32; ++i) { const int kk = 2 * i + (lane >> 5); float v = W[(size_t)(k0 + kk) * N + n0 + (lane & 31)] * sc; if (gk) v *= gk[k0 + kk]; scr[kk * 33 + (lane & 31)] = v; }
    LDS_WAIT();
    const int c = lane & 7;
#pragma unroll
    for (int j = 0; j < 4; ++j) { const int n = (lane >> 3) + 8 * j; const LAS float* s = scr + (8 * c) * 33 + n;
        u32x4 o; o.x = cvtpk(s[0 * 33], s[1 * 33]); o.y = cvtpk(s[2 * 33], s[3 * 33]); o.z = cvtpk(s[4 * 33], s[5 * 33]); o.w = cvtpk(s[6 * 33], s[7 * 33]);
        *(u32x4*)(WT + (size_t)(n0 + n) * K + k0 + 8 * c) = o; }
    LDS_WAIT();
}
__device__ __forceinline__ void rms_row_to_bf16(const float* xrow, bf16* orow, int lane) {
    const f32x4* xr = (const f32x4*)xrow + lane;
    f32x4 v[4]; float s = 0.f;
#pragma unroll
    for (int j = 0; j < 4; ++j) { v[j] = xr[64 * j]; s += (v[j].x * v[j].x + v[j].y * v[j].y) + (v[j].z * v[j].z + v[j].w * v[j].w); }
    const float rstd = 1.f / sqrtf(wave_sum(s) * (1.f / DM) + EPS);
    u32x2* o8 = (u32x2*)orow + lane;
#pragma unroll
    for (int j = 0; j < 4; ++j) { u32x2 w; w.x = cvtpk(v[j].x * rstd, v[j].y * rstd); w.y = cvtpk(v[j].z * rstd, v[j].w * rstd); o8[64 * j] = w; }
}

template <bool F32> __device__ __forceinline__ void stage_v(const void* vbase, size_t pitch, LAS unsigned char* vst, int lane) {
#pragma unroll
    for (int i = 0; i < 4; ++i) {
        const int piece = i * 64 + lane, key = piece >> 3, ch = piece & 7;
        bf16x8 v;
        if (F32) { const float* p = (const float*)vbase + (size_t)key * pitch + ch * 8; v = pack8(*(const f32x4*)p, *(const f32x4*)(p + 4)); }
        else v = *(const bf16x8*)((const bf16*)vbase + (size_t)key * pitch + ch * 8);
        *(LAS bf16x8*)(vst + ((key >> 3) * 2 + (ch >> 2)) * 512 + (key & 7) * 64 + (ch & 3) * 16) = v;
    }
}
typedef short v4i16_t __attribute__((ext_vector_type(4)));
__device__ __forceinline__ s16x4 vtr(LAS unsigned char* p) { return __builtin_bit_cast(s16x4, __builtin_amdgcn_ds_read_tr16_b64_v4i16((LAS v4i16_t*)p)); }
__device__ __forceinline__ void pv_block(f32x16 (&o)[2], LAS unsigned char* vst, const bf16x8 (&pb)[2], int lane) {
    const int h = lane >> 5, i16 = lane & 15, q = i16 >> 2, p = i16 & 3, G1 = (lane >> 4) & 1;
    LAS unsigned char* vb = vst + (4 * h + q) * 64 + 32 * G1 + 8 * p;
    asm volatile("" ::: "memory");
#pragma unroll
    for (int s = 0; s < 2; ++s)
#pragma unroll
        for (int d0 = 0; d0 < 2; ++d0) {
            const s16x4 lo = vtr(vb + (4 * s + d0) * 512), hi = vtr(vb + (4 * s + 2 + d0) * 512);
            const bf16x8 vf = __builtin_shufflevector(lo, hi, 0, 1, 2, 3, 4, 5, 6, 7);
            o[d0] = MFMA32(vf, pb[s], o[d0]);
        }
    asm volatile("" ::: "memory");
}
__device__ __forceinline__ void pack_p(const float (&p)[16], bf16x8 (&pb)[2]) {
#pragma unroll
    for (int s = 0; s < 2; ++s) { u32x4 w; w.x = cvtpk(p[8 * s], p[8 * s + 1]); w.y = cvtpk(p[8 * s + 2], p[8 * s + 3]); w.z = cvtpk(p[8 * s + 4], p[8 * s + 5]); w.w = cvtpk(p[8 * s + 6], p[8 * s + 7]); pb[s] = __builtin_bit_cast(bf16x8, w); }
}
__device__ __forceinline__ float silu(float g) { return g * __builtin_amdgcn_rcpf(1.0f + __builtin_amdgcn_exp2f(-1.4426950408889634f * g)); }
__device__ __forceinline__ void store_gated(const f32x16 (&o)[2], float rowscale, const bf16* gate_row, bf16* mix_row, const float* dscale, int h) {
#pragma unroll
    for (int db = 0; db < 2; ++db)
#pragma unroll
        for (int g4 = 0; g4 < 4; ++g4) {
            const int d = 32 * db + 8 * g4 + 4 * h;
            const u32x2 gw = *(const u32x2*)(gate_row + d);
            f32x4 sc = {rowscale, rowscale, rowscale, rowscale};
            if (dscale) { const f32x4 ds = *(const f32x4*)(dscale + d); sc = sc * ds; }
            const float v0 = o[db][4 * g4 + 0] * sc.x * silu(bf_lo(gw.x)), v1 = o[db][4 * g4 + 1] * sc.y * silu(bf_hi(gw.x));
            const float v2 = o[db][4 * g4 + 2] * sc.z * silu(bf_lo(gw.y)), v3 = o[db][4 * g4 + 3] * sc.w * silu(bf_hi(gw.y));
            u32x2 w; w.x = cvtpk(v0, v1); w.y = cvtpk(v2, v3);
            *(u32x2*)(mix_row + d) = w;
        }
}

struct SbSrc { const bf16* kz; const bf16* vz; const float* kc; const float* vc; int nb_cache; };
__device__ __forceinline__ void sb_item(LAS unsigned char* vst, const bf16* qrow0  , const SbSrc S, int vq  ,
                                        const bf16* gate_row0, bf16* mix_row0, int lane) {
    const int r32 = lane & 31, h = lane >> 5;
    bf16x8 qf[4];
#pragma unroll
    for (int d0 = 0; d0 < 4; ++d0) qf[d0] = *(const bf16x8*)(qrow0 + (size_t)r32 * NIN + 16 * d0 + 8 * h);
    f32x16 o[2]; o[0] = f32x16{}; o[1] = f32x16{};
    float carry = 0.f;
    for (int vb = vq; vb >= 0; --vb) {
        bf16x8 kf[4];
        const bool cache = vb < S.nb_cache;
        if (!cache) { const bf16* p = S.kz + (size_t)((vb - S.nb_cache) * 32 + r32) * NIN + 8 * h;
#pragma unroll
            for (int d0 = 0; d0 < 4; ++d0) kf[d0] = *(const bf16x8*)(p + 16 * d0);
            stage_v<false>(S.vz + (size_t)((vb - S.nb_cache) * 32) * NIN, NIN, vst, lane);
        } else { const float* p = S.kc + (size_t)(vb * 32 + r32) * 512 + 8 * h;
#pragma unroll
            for (int d0 = 0; d0 < 4; ++d0) kf[d0] = pack8(*(const f32x4*)(p + 16 * d0), *(const f32x4*)(p + 16 * d0 + 4));
            stage_v<true>(S.vc + (size_t)(vb * 32) * 512, 512, vst, lane);
        }
        f32x16 s = f32x16{};
#pragma unroll
        for (int d0 = 0; d0 < 4; ++d0) s = MFMA32(kf[d0], qf[d0], s);
        float lr[16], lb[16];
        const bool diag = (vb == vq);
#pragma unroll
        for (int r = 0; r < 16; ++r) {
            const float z = s[r], e = __builtin_amdgcn_exp2f(-__builtin_fabsf(z)), l = __builtin_amdgcn_logf(1.0f + e);
            lr[r] = -(__builtin_fmaxf(z, 0.f) + l);
            lb[r] = __builtin_fminf(z, 0.f) - l;
            if (diag && !(crow(r, h) < r32)) lr[r] = 0.f;
        }
        float gs[4], ot[4], R[4];
#pragma unroll
        for (int g = 0; g < 4; ++g) { gs[g] = (lr[4 * g] + lr[4 * g + 1]) + (lr[4 * g + 2] + lr[4 * g + 3]); ot[g] = __shfl_xor(gs[g], 32); }
        R[3] = 0.f; R[2] = gs[3] + ot[3]; R[1] = R[2] + (gs[2] + ot[2]); R[0] = R[1] + (gs[1] + ot[1]);
        const float total = R[0] + (gs[0] + ot[0]);
        float p[16];
#pragma unroll
        for (int g = 0; g < 4; ++g) {
            float t = carry + R[g] + (h == 0 ? ot[g] : 0.f);
            p[4 * g + 3] = __builtin_amdgcn_exp2f(lb[4 * g + 3] + t); t += lr[4 * g + 3];
            p[4 * g + 2] = __builtin_amdgcn_exp2f(lb[4 * g + 2] + t); t += lr[4 * g + 2];
            p[4 * g + 1] = __builtin_amdgcn_exp2f(lb[4 * g + 1] + t); t += lr[4 * g + 1];
            p[4 * g + 0] = __builtin_amdgcn_exp2f(lb[4 * g + 0] + t);
        }
        if (diag) {
#pragma unroll
            for (int r = 0; r < 16; ++r) if (!(crow(r, h) < r32)) p[r] = 0.f;
        }
        carry += total;
        bf16x8 pb[2]; pack_p(p, pb);
        pv_block(o, vst, pb, lane);
        if (__all(carry < -126.0f)) break;
    }
    store_gated(o, 1.0f, gate_row0 + (size_t)r32 * NIN, mix_row0 + (size_t)r32 * DM, nullptr, h);
}

__device__ __forceinline__ void xa_item(LAS unsigned char* vst, const bf16* qrow0, const bf16* mk, const bf16* mv  , const bf16* gate_row0, bf16* mix_row0, int lane) {
    const int r32 = lane & 31, h = lane >> 5;
    bf16x8 qf[4];
#pragma unroll
    for (int d0 = 0; d0 < 4; ++d0) qf[d0] = *(const bf16x8*)(qrow0 + (size_t)r32 * NIN + 16 * d0 + 8 * h);
    f32x16 o[2]; o[0] = f32x16{}; o[1] = f32x16{};
    float mrun = -1e30f, lsum = 0.f;
    for (int kb = 0; kb < NMEM / 32; ++kb) {
        bf16x8 kf[4];
        const bf16* p = mk + (size_t)(kb * 32 + r32) * 256 + 8 * h;
#pragma unroll
        for (int d0 = 0; d0 < 4; ++d0) kf[d0] = *(const bf16x8*)(p + 16 * d0);
        stage_v<false>(mv + (size_t)(kb * 32) * 256, 256, vst, lane);
        f32x16 s = f32x16{};
#pragma unroll
        for (int d0 = 0; d0 < 4; ++d0) s = MFMA32(kf[d0], qf[d0], s);
        float bm = s[0];
#pragma unroll
        for (int r = 1; r < 16; ++r) bm = __builtin_fmaxf(bm, s[r]);
        bm = __builtin_fmaxf(bm, __shfl_xor(bm, 32));
        const float mnew = __builtin_fmaxf(mrun, bm), f = __builtin_amdgcn_exp2f(mrun - mnew);
        float p16[16], ps = 0.f;
#pragma unroll
        for (int r = 0; r < 16; ++r) { p16[r] = __builtin_amdgcn_exp2f(s[r] - mnew); ps += p16[r]; }
        lsum = lsum * f + ps; mrun = mnew;
#pragma unroll
        for (int r = 0; r < 16; ++r) { o[0][r] *= f; o[1][r] *= f; }
        bf16x8 pb[2]; pack_p(p16, pb);
        pv_block(o, vst, pb, lane);
    }
    lsum += __shfl_xor(lsum, 32);
    store_gated(o, 1.0f / lsum, gate_row0 + (size_t)r32 * NIN, mix_row0 + (size_t)r32 * DM, nullptr, h);
}

__device__ __forceinline__ void pool_item(const bf16* zrow0  , int t0  , bool sample, const float* hist  ,
                                          int g, const bf16* poolwt  , const float* pool_scale, bf16* mix_row0, int lane) {
    const int r32 = lane & 31, h = lane >> 5, w = 2 << g, tl = t0 + r32;
    const float inv = sample ? 1.0f / (float)w : 1.0f / (float)((tl + 1 < w) ? tl + 1 : w);
    bf16x8 pf[4];
#pragma unroll
    for (int d0 = 0; d0 < 4; ++d0) {
        const int c = ZU + 64 * g + 16 * d0 + 8 * h;
        float acc[8], u0[8];
#pragma unroll
        for (int j = 0; j < 8; ++j) acc[j] = 0.f;
        for (int i = 0; i < w; ++i) {
            const int tt = tl - i;
            float v[8];
            if (tt >= 0) { const u32x4 x = *(const u32x4*)(zrow0 + (ptrdiff_t)(r32 - i) * NIN + c);
                v[0] = bf_lo(x.x); v[1] = bf_hi(x.x); v[2] = bf_lo(x.y); v[3] = bf_hi(x.y); v[4] = bf_lo(x.z); v[5] = bf_hi(x.z); v[6] = bf_lo(x.w); v[7] = bf_hi(x.w); }
            else if (sample) { const float* hp = hist + (size_t)(15 + tt) * 256 + (c - ZU); const f32x4 a = *(const f32x4*)hp, b = *(const f32x4*)(hp + 4);
                v[0] = a.x; v[1] = a.y; v[2] = a.z; v[3] = a.w; v[4] = b.x; v[5] = b.y; v[6] = b.z; v[7] = b.w; }
            else {
#pragma unroll
                for (int j = 0; j < 8; ++j) v[j] = 0.f; }
#pragma unroll
            for (int j = 0; j < 8; ++j) { acc[j] += v[j]; if (i == 0) u0[j] = v[j]; }
        }
        f32x4 a = {acc[0] * inv - u0[0], acc[1] * inv - u0[1], acc[2] * inv - u0[2], acc[3] * inv - u0[3]}, b = {acc[4] * inv - u0[4], acc[5] * inv - u0[5], acc[6] * inv - u0[6], acc[7] * inv - u0[7]};
        pf[d0] = pack8(a, b);
    }
    f32x16 o[2]; o[0] = f32x16{}; o[1] = f32x16{};
#pragma unroll
    for (int db = 0; db < 2; ++db)
#pragma unroll
        for (int d0 = 0; d0 < 4; ++d0) { const bf16x8 wf = *(const bf16x8*)(poolwt + (size_t)(g * 64 + 32 * db + r32) * 64 + 16 * d0 + 8 * h); o[db] = MFMA32(wf, pf[d0], o[db]); }
    store_gated(o, 1.0f, zrow0 + (size_t)r32 * NIN + ZGP + 64 * g, mix_row0 + (size_t)r32 * DM + 512 + 64 * g, pool_scale + 64 * g, h);
}

__global__ void __launch_bounds__(512, 2) fwd_mega(Args a) {
    extern __shared__ __attribute__((aligned(16))) unsigned char lds_raw[];
    LAS unsigned char* lds = (LAS unsigned char*)lds_raw;
    cg::grid_group grid = cg::this_grid();
    const int tid = threadIdx.x, lane = tid & 63, wave = __builtin_amdgcn_readfirstlane(tid >> 6);
    const int G = gridDim.x, bx = blockIdx.x;
    const int gw = bx * 8 + wave, NGW = G * 8;
    unsigned char* ws = a.ws;
    bf16* WIN = (bf16*)(ws + WS_WIN); bf16* WOUT = (bf16*)(ws + WS_WOUT); bf16* WMEM = (bf16*)(ws + WS_WMEM); bf16* POOLW = (bf16*)(ws + WS_POOLW);
    bf16* MEMN = (bf16*)(ws + WS_MEMN); bf16* MEMK = (bf16*)(ws + WS_MEMK); bf16* MEMV = (bf16*)(ws + WS_MEMV); float* ROWSS = (float*)(ws + WS_ROWSS);
    bf16* XN = (bf16*)(ws + WS_XN); bf16* Z = (bf16*)(ws + WS_Z); bf16* MIX = (bf16*)(ws + WS_MIX);

    {
        LAS float* scr = (LAS float*)(lds + wave * 16384);
        constexpr int I_IN = (DM / 64) * (NIN / 32), I_OUT = (DM / 64) * (DM / 32), I_MEM = (DM / 64) * (512 / 32), I_PW = 4 * 2;
        for (int it = gw; it < I_IN + I_OUT + I_MEM + I_PW; it += NGW) {
            int r = it;
            if (r < I_IN) { const int n0 = 32 * (r % (NIN / 32)); const float sc = (n0 < ZK || (n0 >= ZQX && n0 < ZGX)) ? C2 : 1.0f; transpose_item(a.w_in, DM, NIN, WIN, scr, r, lane, a.g_norm, sc); continue; } r -= I_IN;
            if (r < I_OUT) { transpose_item(a.w_out, DM, DM, WOUT, scr, r, lane, nullptr, 1.0f); continue; } r -= I_OUT;
            if (r < I_MEM) { transpose_item(a.w_mem_kv, DM, 512, WMEM, scr, r, lane, a.g_mem, 1.0f); continue; } r -= I_MEM;
            transpose_item(a.pool_w + (size_t)(r >> 1) * 4096, 64, 64, POOLW + (size_t)(r >> 1) * 4096, scr, r & 1, lane, nullptr, 1.0f);
        }
        for (int m = gw; m < MT + 512; m += NGW) {
            if (m < MP) rms_row_to_bf16(a.x_prompt + (size_t)m * DM, XN + (size_t)m * DM, lane);
            else if (m < MT) rms_row_to_bf16(a.x_sample + (size_t)(m - MP) * DM, XN + (size_t)m * DM, lane);
            else rms_row_to_bf16(a.mem_prompt + (size_t)(m - MT) * DM, MEMN + (size_t)(m - MT) * DM, lane);
        }
        for (int c = gw; c < 2 * (16 * 256 * 256 / 512); c += NGW) {
            const int which = c / (16 * 256 * 256 / 512), cc = c % (16 * 256 * 256 / 512);
            const float* src = (which ? a.cache_mv : a.cache_mk) + (size_t)cc * 512 + lane * 8;
            bf16* dst = (which ? MEMV : MEMK) + (size_t)2 * 65536 + (size_t)cc * 512 + lane * 8;
            *(bf16x8*)dst = pack8(*(const f32x4*)src, *(const f32x4*)(src + 4));
        }
    }
    grid.sync();

    {
        pg8::Gemm g{XN, WIN, MT, NIN, DM}; pg8::StaticOrder S; S.init(MT, NIN, G, bx);
        EpiIn E{Z, a.out};
        pg8::gemm_phase<EpiIn, pg8::StaticOrder, true, true>(lds, g, S, E);
        pg8::Gemm g2{MEMN, WMEM, 512, 512, DM}; pg8::StaticOrder S2; S2.init(512, 512, G, (bx + 4) % G);
        EpiMem E2{MEMK, MEMV, a.out};
        pg8::gemm_phase<EpiMem, pg8::StaticOrder, true, true>(lds, g2, S2, E2);
    }
    grid.sync();

    {
        LAS unsigned char* vst = lds + wave * 4096;
        constexpr int N_SBP = 2 * 256 * 8, N_SBS = 16 * 2 * 8, N_XA = (MT / 32) * 4, N_PL = (MT / 32) * 4;
        for (int it = gw; it < N_SBP + N_SBS + N_XA + N_PL; it += NGW) {
            int r = it;
            if (r < N_SBP) {
                const int hd = r & 7, qb = 255 - ((r >> 3) & 255), b = r >> 11;
                const size_t row0 = (size_t)b * SEQ + 32 * qb;
                SbSrc S{Z + (size_t)b * SEQ * NIN + ZK + 64 * hd, Z + (size_t)b * SEQ * NIN + ZV + 64 * hd, nullptr, nullptr, 0};
                sb_item(vst, Z + row0 * NIN + ZQ + 64 * hd, S, qb, Z + row0 * NIN + ZGS + 64 * hd, MIX + row0 * DM + 64 * hd, lane);
                continue;
            }
            r -= N_SBP;
            if (r < N_SBS) {
                const int hd = r & 7, qb = (r >> 3) & 1, s = r >> 4;
                const size_t row0 = (size_t)MP + s * 64 + 32 * qb, rs = (size_t)MP + s * 64;
                SbSrc S{Z + rs * NIN + ZK + 64 * hd, Z + rs * NIN + ZV + 64 * hd, a.cache_k + ((size_t)s * PAST * 8 + hd) * 64, a.cache_v + ((size_t)s * PAST * 8 + hd) * 64, PAST / 32};
                sb_item(vst, Z + row0 * NIN + ZQ + 64 * hd, S, PAST / 32 + qb, Z + row0 * NIN + ZGS + 64 * hd, MIX + row0 * DM + 64 * hd, lane);
                continue;
            }
            r -= N_SBS;
            if (r < N_XA) {
                const int hd = r & 3, blk = r >> 2; const size_t row0 = (size_t)blk * 32;
                const int seq = (row0 < MP) ? (int)(row0 >> 13) : 2 + (int)((row0 - MP) >> 6);
                xa_item(vst, Z + row0 * NIN + ZQX + 64 * hd, MEMK + (size_t)seq * 65536 + 64 * hd, MEMV + (size_t)seq * 65536 + 64 * hd, Z + row0 * NIN + ZGX + 64 * hd, MIX + row0 * DM + 768 + 64 * hd, lane);
                continue;
            }
            r -= N_XA;
            {
                const int g = 3 - (r & 3), blk = r >> 2; const size_t row0 = (size_t)blk * 32;
                const bool sample = row0 >= MP; const int t0 = sample ? (int)((row0 - MP) & 63) : (int)(row0 & (SEQ - 1));
                const float* hist = sample ? a.state_pool + (size_t)((row0 - MP) >> 6) * 15 * 256 : nullptr;
                pool_item(Z + row0 * NIN, t0, sample, hist, g, POOLW, a.pool_scale, MIX + row0 * DM, lane);
            }
        }
    }
    grid.sync();

    {
        pg8::Gemm g{MIX, WOUT, MT, DM, DM}; pg8::StaticOrder S; S.init(MT, DM, G, bx);
        EpiOut E{a.x_prompt, a.x_sample, a.out, ROWSS};
        pg8::gemm_phase<EpiOut, pg8::StaticOrder, true, true>(lds, g, S, E);
    }
    grid.sync();

    for (int m = gw; m < MT; m += NGW) {
        const f32x4* pr = (const f32x4*)(ROWSS + (size_t)m * 16);
        const f32x4 p0 = pr[0], p1 = pr[1], p2 = pr[2], p3 = pr[3];
        const float ss = ((p0.x + p0.y) + (p0.z + p0.w)) + ((p1.x + p1.y) + (p1.z + p1.w)) + ((p2.x + p2.y) + (p2.z + p2.w)) + ((p3.x + p3.y) + (p3.z + p3.w));
        const float rstd = 1.f / sqrtf(ss * (1.f / DM) + EPS);
        f32x4* yr = (f32x4*)(a.out + O_Y + (size_t)m * DM) + lane; const f32x4* gf = (const f32x4*)a.g_final + lane;
#pragma unroll
        for (int j = 0; j < 4; ++j) { const f32x4 v = yr[64 * j], gg = gf[64 * j]; yr[64 * j] = v * rstd * gg; }
    }
}

extern "C" void kernel_launch(void* const* d_in, const int* in_sizes, int n_in, void* d_out, int out_size, void* d_ws, size_t ws_size, hipStream_t stream) {
    static int grid = 0;
    if (grid == 0) {
        int dev = 0, cus = 0, per_cu = 0;
        if (n_in != 16 || ws_size < WS_END) { fprintf(stderr, "kernel_launch: unexpected inputs (n_in %d, ws %zu)\n", n_in, ws_size); grid = -1; return; }
        (void)hipGetDevice(&dev); (void)hipDeviceGetAttribute(&cus, hipDeviceAttributeMultiprocessorCount, dev);
        if (hipFuncSetAttribute((const void*)fwd_mega, hipFuncAttributeMaxDynamicSharedMemorySize, LDS_BYTES) != hipSuccess) { fprintf(stderr, "kernel_launch: hipFuncSetAttribute failed\n"); grid = -1; return; }
        if (hipOccupancyMaxActiveBlocksPerMultiprocessor(&per_cu, (const void*)fwd_mega, 512, LDS_BYTES) != hipSuccess || per_cu < 1) { fprintf(stderr, "kernel_launch: occupancy query failed (%d)\n", per_cu); (void)hipGetLastError(); per_cu = 1; }
        grid = cus * per_cu;
    }
    if (grid < 0) return;
    Args a{};
    a.x_prompt = (const float*)d_in[0]; a.x_sample = (const float*)d_in[1]; a.cache_k = (const float*)d_in[2]; a.cache_v = (const float*)d_in[3]; a.state_pool = (const float*)d_in[4];
    a.cache_mk = (const float*)d_in[5]; a.cache_mv = (const float*)d_in[6]; a.mem_prompt = (const float*)d_in[7]; a.g_norm = (const float*)d_in[8]; a.w_in = (const float*)d_in[9];
    a.pool_w = (const float*)d_in[10]; a.pool_scale = (const float*)d_in[11]; a.g_mem = (const float*)d_in[12]; a.w_mem_kv = (const float*)d_in[13]; a.w_out = (const float*)d_in[14]; a.g_final = (const float*)d_in[15];
    a.out = (float*)d_out; a.ws = (unsigned char*)d_ws;
    void* args[] = {&a};
    hipError_t e = hipLaunchCooperativeKernel((const void*)fwd_mega, dim3(grid), dim3(512), args, LDS_BYTES, stream);
    if (e != hipSuccess) fprintf(stderr, "kernel_launch: cooperative launch failed: %s (grid %d)\n", hipGetErrorString(e), grid);
}
```
